# Optimizing an MI355X kernel written in HIP

```python
import math
import jax, jax.numpy as jnp
from jax import lax
import numpy as np

D_MODEL = 1024
BATCH = 8
SEQ = 2048
DEPTH = 2
DEC_BATCH = 128
DEC_SEQ = 1
PAST_LEN = 16384
PAGE_SIZE = 128

HG_HEADS = 4
HG_DK = 128
HG_DV = 128
HG_WIDTH = HG_HEADS * HG_DK
GLA_CHUNK = 64
GM_GROUPS = 4
GM_CHUNK = 128
GM_WIDTH = 512
GM_GC = GM_WIDTH // GM_GROUPS
S5_WIDTH = 512
S5_GROUP = 16
S5_GROUPS = S5_WIDTH // S5_GROUP
S5_STATE = 64
N_BRANCH = 3
BRANCH_W = 512
D_FF = 2816
N_IN = 4 * HG_WIDTH + 2 * GM_WIDTH + S5_WIDTH + N_BRANCH * D_MODEL
EPS = 1e-6

kernel_name = 'hybrid_hgrn2_gmlp_s5_decoder_step'

F32 = jnp.float32


def rms_norm(x, g):
    xf = x.astype(F32)
    y = xf * lax.rsqrt(jnp.mean(xf * xf, axis=-1, keepdims=True) + EPS)
    return (y * g.astype(F32)).astype(x.dtype)


def layer_norm(x, g, b):
    xf = x.astype(F32)
    mu = jnp.mean(xf, axis=-1, keepdims=True)
    var = jnp.mean(jnp.square(xf - mu), axis=-1, keepdims=True)
    y = (xf - mu) * lax.rsqrt(var + EPS) * g.astype(F32) + b.astype(F32)
    return y.astype(x.dtype)


def swiglu(x, wg, wu, wd):
    return (jax.nn.silu(x @ wg) * (x @ wu)) @ wd


def gla_chunked(q, k, v, logf, s0):
    B, L, H, K = q.shape
    V = v.shape[-1]
    c = math.gcd(L, GLA_CHUNK)
    n = L // c

    def to_chunks(a):
        return a.reshape(B, n, c, H, a.shape[-1]).swapaxes(0, 1)

    mask = jnp.tril(jnp.ones((c, c), dtype=bool))[None, :, :, None, None]

    def step(S, inp):
        qc, kc, vc, gc = inp
        b = jnp.cumsum(gc, axis=1)
        b_last = b[:, -1]
        o_inter = jnp.einsum('bthk,bhkv->bthv', qc * jnp.exp(b), S)
        rel = jnp.where(mask, b[:, :, None] - b[:, None, :], -jnp.inf)
        scores = jnp.einsum('bthk,btshk,bshk->btsh', qc, jnp.exp(rel), kc)
        o_intra = jnp.einsum('btsh,bshv->bthv', scores, vc)
        S_new = jnp.exp(b_last)[..., None] * S + jnp.einsum(
            'bshk,bshv->bhkv', kc * jnp.exp(b_last[:, None] - b), vc)
        return S_new, o_inter + o_intra

    S_fin, o = lax.scan(step, s0, (to_chunks(q), to_chunks(k), to_chunks(v), to_chunks(logf)))
    return o.swapaxes(0, 1).reshape(B, L, H, V), S_fin


def hgrn2_mixer(xq, xf, xi, xg, s0, lb, norm_g):
    B, L, _ = xq.shape

    def heads(a):
        return a.astype(F32).reshape(B, L, HG_HEADS, -1)

    zf = heads(xf)
    lbh = lb.astype(F32).reshape(HG_HEADS, HG_DK)
    logf = jnp.logaddexp(jnp.log(lbh), jnp.log1p(-lbh) + jax.nn.log_sigmoid(zf))
    k = (1.0 - lbh) * jax.nn.sigmoid(-zf)
    o, S = gla_chunked(heads(xq), k, heads(xi), logf, s0.astype(F32))
    o = o * lax.rsqrt(jnp.mean(o * o, axis=-1, keepdims=True) + EPS)
    o = o * norm_g.astype(F32).reshape(HG_HEADS, HG_DV)
    o = o.reshape(B, L, HG_WIDTH) * jax.nn.silu(xg.astype(F32))
    return o.astype(xq.dtype), S


def gmlp_mixer(xu, xv, ws, bs, ng, nb):
    B, L, _ = xu.shape
    u = jax.nn.gelu(xu)
    v = layer_norm(jax.nn.gelu(xv), ng, nb)
    n = -(-L // GM_CHUNK)
    pad = n * GM_CHUNK - L
    vp = jnp.pad(v, ((0, 0), (0, pad), (0, 0))).reshape(B, n, GM_CHUNK, GM_GROUPS, GM_GC)
    wm = ws * jnp.tril(jnp.ones((GM_CHUNK, GM_CHUNK), dtype=ws.dtype))
    mix = jnp.einsum('gts,bnsgc->bntgc', wm, vp) + bs.T[None, None, :, :, None]
    mix = mix.reshape(B, n * GM_CHUNK, GM_WIDTH)[:, :L]
    return u * mix, v


def _ssm_combine(c1, c2):
    a1, b1 = c1
    a2, b2 = c2
    return a1 * a2, a2 * b1 + b2


def s5_mixer(u, h0_re, h0_im, lam_re, lam_im, log_dt, b_re, b_im, c_re, c_im, d_skip, glu_w, glu_b):
    Bsz, L, _ = u.shape
    uf = u.astype(F32).reshape(Bsz, L, S5_GROUPS, S5_GROUP)
    lam = lax.complex(lam_re.astype(F32), lam_im.astype(F32))
    dt = jnp.exp(log_dt.astype(F32))[:, None]
    abar = jnp.exp(lam * dt)
    bbar = ((abar - 1.0) / lam)[..., None] * lax.complex(b_re.astype(F32), b_im.astype(F32))
    bu = lax.complex(jnp.einsum('gph,blgh->blgp', jnp.real(bbar), uf),
                     jnp.einsum('gph,blgh->blgp', jnp.imag(bbar), uf))
    h0 = lax.complex(h0_re.astype(F32), h0_im.astype(F32))
    bu = bu.at[:, 0].add(abar * h0)
    a = jnp.broadcast_to(abar, bu.shape)
    _, h = lax.associative_scan(_ssm_combine, (a, bu), axis=1)
    y = (jnp.einsum('ghp,blgp->blgh', c_re.astype(F32), jnp.real(h))
         - jnp.einsum('ghp,blgp->blgh', c_im.astype(F32), jnp.imag(h)))
    y = y.reshape(Bsz, L, S5_WIDTH) + d_skip.astype(F32) * u.astype(F32)
    z = jax.nn.gelu(y).astype(u.dtype)
    zz = z @ glu_w + glu_b
    out = zz[..., :S5_WIDTH] * jax.nn.sigmoid(zz[..., S5_WIDTH:])
    h_last = h[:, -1]
    return out, jnp.real(h_last), jnp.imag(h_last)


def decoder_layer(x, s_hg, h_re, h_im, lb, norm_g, ffn_w_gate, ffn_w_up, ffn_w_down, w_in,
                  hgrn_norm_g, gmlp_ws, gmlp_bs, gmlp_norm_g, gmlp_norm_b,
                  s5_lam_re, s5_lam_im, s5_log_dt, s5_b_re, s5_b_im, s5_c_re, s5_c_im, s5_d,
                  s5_glu_w, s5_glu_b, w_branch, w_out):
    B, L, _ = x.shape
    h = rms_norm(x, norm_g[0])
    x = x + 0.5 * rms_norm(swiglu(h, ffn_w_gate[0], ffn_w_up[0], ffn_w_down[0]), norm_g[1])
    h = rms_norm(x, norm_g[2])
    proj = h @ w_in
    sizes = [HG_WIDTH] * 4 + [GM_WIDTH] * 2 + [S5_WIDTH] + [N_BRANCH * D_MODEL]
    xq, xf, xi, xg, gu, gv, su, gate_cols = jnp.split(proj, np.cumsum(sizes)[:-1].tolist(), axis=-1)
    a_out, s_hg_new = hgrn2_mixer(xq, xf, xi, xg, s_hg, lb, hgrn_norm_g)
    b_out, v_rows = gmlp_mixer(gu, gv, gmlp_ws, gmlp_bs, gmlp_norm_g, gmlp_norm_b)
    c_out, h_re_new, h_im_new = s5_mixer(su, h_re, h_im, s5_lam_re, s5_lam_im, s5_log_dt,
                                         s5_b_re, s5_b_im, s5_c_re, s5_c_im, s5_d, s5_glu_w, s5_glu_b)
    branches = jnp.stack([a_out, b_out, c_out], axis=2)
    bproj = jnp.einsum('blnw,nwd->blnd', branches, w_branch)
    gates = jax.nn.sigmoid(gate_cols).reshape(B, L, N_BRANCH, D_MODEL)
    merged = jnp.einsum('blnd,blnd->bld', gates, bproj)
    x = x + rms_norm(merged @ w_out, norm_g[3])
    h = rms_norm(x, norm_g[4])
    x = x + 0.5 * rms_norm(swiglu(h, ffn_w_gate[1], ffn_w_up[1], ffn_w_down[1]), norm_g[5])
    return x, s_hg_new, h_re_new, h_im_new, v_rows


def setup_inputs(seed: int = 0) -> dict:
    key = jax.random.key(seed)
    ks = jax.random.split(key, 32)

    def nrm(k, shape, scale):
        return scale * jax.random.normal(k, shape, dtype=F32)

    P = S5_STATE
    G = S5_GROUPS
    return {
        'x_prompt': nrm(ks[0], (BATCH, SEQ, D_MODEL), 1.0),
        'x_sample': nrm(ks[1], (DEC_BATCH, DEC_SEQ, D_MODEL), 1.0),
        'state_hgrn': nrm(ks[2], (DEPTH, DEC_BATCH, HG_HEADS, HG_DK, HG_DV), 0.3),
        'state_s5_re': nrm(ks[3], (DEPTH, DEC_BATCH, G, P), 0.1),
        'state_s5_im': nrm(ks[4], (DEPTH, DEC_BATCH, G, P), 0.1),
        'norm_g': 1.0 + nrm(ks[5], (DEPTH, 6, D_MODEL), 0.05),
        'ffn_w_gate': nrm(ks[6], (DEPTH, 2, D_MODEL, D_FF), D_MODEL ** -0.5),
        'ffn_w_up': nrm(ks[7], (DEPTH, 2, D_MODEL, D_FF), D_MODEL ** -0.5),
        'ffn_w_down': nrm(ks[8], (DEPTH, 2, D_FF, D_MODEL), D_FF ** -0.5),
        'w_in': nrm(ks[9], (DEPTH, D_MODEL, N_IN), D_MODEL ** -0.5),
        'hgrn_lb_logits': 1.0 + nrm(ks[10], (DEPTH, HG_WIDTH), 0.1),
        'hgrn_norm_g': 1.0 + nrm(ks[11], (DEPTH, HG_WIDTH), 0.05),
        'gmlp_ws': nrm(ks[12], (DEPTH, GM_GROUPS, GM_CHUNK, GM_CHUNK), GM_CHUNK ** -0.5),
        'gmlp_bs': 1.0 + nrm(ks[13], (DEPTH, GM_GROUPS, GM_CHUNK), 0.01),
        'gmlp_norm_g': 1.0 + nrm(ks[14], (DEPTH, GM_WIDTH), 0.05),
        'gmlp_norm_b': nrm(ks[15], (DEPTH, GM_WIDTH), 0.01),
        's5_lam_re': -0.5 + nrm(ks[16], (DEPTH, G, P), 0.01),
        's5_lam_im': jnp.pi * jnp.arange(P, dtype=F32)[None, None, :] + nrm(ks[17], (DEPTH, G, P), 0.01),
        's5_log_dt': jax.random.uniform(ks[18], (DEPTH, G), dtype=F32,
                                        minval=math.log(1e-3), maxval=math.log(1e-1)),
        's5_b_re': nrm(ks[19], (DEPTH, G, P, S5_GROUP), (2 * S5_GROUP) ** -0.5),
        's5_b_im': nrm(ks[20], (DEPTH, G, P, S5_GROUP), (2 * S5_GROUP) ** -0.5),
        's5_c_re': nrm(ks[21], (DEPTH, G, S5_GROUP, P), (2 * P) ** -0.5),
        's5_c_im': nrm(ks[22], (DEPTH, G, S5_GROUP, P), (2 * P) ** -0.5),
        's5_d': nrm(ks[23], (DEPTH, S5_WIDTH), 0.5),
        's5_glu_w': nrm(ks[24], (DEPTH, S5_WIDTH, 2 * S5_WIDTH), S5_WIDTH ** -0.5),
        's5_glu_b': nrm(ks[25], (DEPTH, 2 * S5_WIDTH), 0.01),
        'w_branch': nrm(ks[26], (DEPTH, N_BRANCH, BRANCH_W, D_MODEL), BRANCH_W ** -0.5),
        'w_out': nrm(ks[27], (DEPTH, D_MODEL, D_MODEL), D_MODEL ** -0.5),
    }


def reference(x_prompt, x_sample, state_hgrn, state_s5_re, state_s5_im, norm_g, ffn_w_gate, ffn_w_up,
              ffn_w_down, w_in, hgrn_lb_logits, hgrn_norm_g, gmlp_ws, gmlp_bs, gmlp_norm_g, gmlp_norm_b,
              s5_lam_re, s5_lam_im, s5_log_dt, s5_b_re, s5_b_im, s5_c_re, s5_c_im, s5_d, s5_glu_w,
              s5_glu_b, w_branch, w_out):
    lb_all = jnp.cumsum(jax.nn.softmax(hgrn_lb_logits.astype(F32), axis=0), axis=0)
    lb_all = lb_all - lb_all[:1]
    yp = x_prompt
    ys = x_sample
    hg_p, re_p, im_p, hg_s, re_s, im_s, v_s = [], [], [], [], [], [], []
    for l in range(DEPTH):
        p = (lb_all[l], norm_g[l], ffn_w_gate[l], ffn_w_up[l], ffn_w_down[l], w_in[l],
             hgrn_norm_g[l], gmlp_ws[l], gmlp_bs[l], gmlp_norm_g[l], gmlp_norm_b[l],
             s5_lam_re[l], s5_lam_im[l], s5_log_dt[l], s5_b_re[l], s5_b_im[l], s5_c_re[l], s5_c_im[l],
             s5_d[l], s5_glu_w[l], s5_glu_b[l], w_branch[l], w_out[l])
        zero_hg = jnp.zeros((BATCH, HG_HEADS, HG_DK, HG_DV), F32)
        zero_s5 = jnp.zeros((BATCH, S5_GROUPS, S5_STATE), F32)
        yp, s1, r1, i1, _ = decoder_layer(yp, zero_hg, zero_s5, zero_s5, *p)
        ys, s2, r2, i2, v2 = decoder_layer(ys, state_hgrn[l], state_s5_re[l], state_s5_im[l], *p)
        hg_p.append(s1)
        re_p.append(r1)
        im_p.append(i1)
        hg_s.append(s2)
        re_s.append(r2)
        im_s.append(i2)
        v_s.append(v2)
    return (yp, ys, jnp.stack(hg_p), jnp.stack(re_p), jnp.stack(im_p),
            jnp.stack(hg_s), jnp.stack(re_s), jnp.stack(im_s), jnp.stack(v_s))
```

```cpp
#include <hip/hip_runtime.h>
#include <hip/hip_cooperative_groups.h>
#include <cstdio>
namespace cg = cooperative_groups;

#ifndef MK_ONE_LAUNCH
#define MK_ONE_LAUNCH 0
#endif

#define LAS __attribute__((address_space(3)))
typedef unsigned short bf16_t;
typedef short bf16x8 __attribute__((ext_vector_type(8)));
typedef float f32x4 __attribute__((ext_vector_type(4)));
typedef float f32x2 __attribute__((ext_vector_type(2)));
typedef unsigned u32x4 __attribute__((ext_vector_type(4)));
typedef unsigned u32x2 __attribute__((ext_vector_type(2)));

constexpr int DM = 1024, FF = 2816, NIN = 6656, DEPTH = 2;
constexpr int MP = 16384, MS = 128, MREAL = MP + MS, MPAD = 16640;
constexpr int SEQ = 2048, NB = 8;
constexpr int C_XQ = 0, C_GU = 512, C_SU = 1024, C_XF = 1536, C_XI = 2048, C_XG = 2560, C_GV = 3072, C_GATE = 3584;
constexpr float EPS = 1e-6f;

constexpr size_t O_YP = 0, O_YS = 16777216, O_HGP = 16908288, O_REP = 17956864, O_IMP = 17989632, O_HGS = 18022400, O_RES = 34799616, O_IMS = 35323904, O_VS = 35848192;

constexpr size_t MiB = 1u << 20;
constexpr size_t WS_CTL = 0;
constexpr size_t WS_TAB = 1 * MiB;
constexpr size_t WS_E = 2 * MiB;
constexpr size_t WS_DEC = 4 * MiB;
constexpr size_t WS_W = 8 * MiB;
constexpr size_t WS_H = 64 * MiB;
constexpr size_t WS_P = 98 * MiB;
constexpr size_t WS_Y = WS_P + 128 * MiB;
constexpr size_t WS_END = WS_P + 212 * MiB;
constexpr size_t T_LB = 0;
constexpr size_t T_ABAR = 4096;
constexpr size_t T_A128 = T_ABAR + 16384;
constexpr size_t T_BBAR = T_A128 + 16384;
constexpr size_t T_CC = T_BBAR + 131072;
constexpr size_t W_GU0 = 0;
constexpr size_t W_D0 = W_GU0 + (size_t)5632 * 1024;
constexpr size_t W_IN = W_D0 + (size_t)1024 * 2816;
constexpr size_t W_GLU = W_IN + (size_t)6656 * 1024;
constexpr size_t W_BR = W_GLU + (size_t)1024 * 512;
constexpr size_t W_OUT = W_BR + (size_t)1024 * 1536;
constexpr size_t W_GU1 = W_OUT + (size_t)1024 * 1024;
constexpr size_t W_D1 = W_GU1 + (size_t)5632 * 1024;
constexpr size_t W_TOTAL = W_D1 + (size_t)1024 * 2816;
static_assert(W_TOTAL * 2 <= 56 * MiB, "weights region");

constexpr int LDS_BYTES = 147456;

__device__ __forceinline__ float bf2f(bf16_t b) { return __uint_as_float(((unsigned)b) << 16); }
__device__ __forceinline__ unsigned f2bf(float f) { unsigned u = __float_as_uint(f); return (u + 0x7fffu + ((u >> 16) & 1u)) >> 16; }
__device__ __forceinline__ unsigned pk2(float lo, float hi) { return f2bf(lo) | (f2bf(hi) << 16); }
__device__ __forceinline__ float sigmoidf_(float x) { return 1.0f / (1.0f + __expf(-x)); }
__device__ __forceinline__ float siluf_(float x) { return x * sigmoidf_(x); }
__device__ __forceinline__ float geluf_(float x) { return x * sigmoidf_(1.5957691216057308f * (x + 0.044715f * x * x * x)); }
__device__ __forceinline__ float wave_sum(float v) {
#pragma unroll
    for (int o = 1; o < 64; o <<= 1) v += __shfl_xor(v, o);
    return v;
}
#define LDS_WAIT() asm volatile("s_waitcnt lgkmcnt(0)" ::: "memory")
__device__ __forceinline__ int otid() { int t = threadIdx.x; asm volatile("" : "+v"(t)); return t; }

namespace pg8 {
constexpr int BM = 256, BK = 64, HALF = 128, HTB = HALF * BK * 2, STAGE_BYTES = 8 * HTB, NXCD = 8, WGM = 8;
__host__ __device__ __forceinline__ int lds_byte(int r, int c) { const int st = (r >> 4) * 2 + (c >> 5), rr = r & 15, cc = c & 31, ob = rr * 64 + cc * 2; return st * 1024 + (ob ^ (((ob >> 9) & 1) << 5)); }
__host__ __device__ __forceinline__ void stage_rc(int b, int& R, int& C) { const int st = b / 1024, sb = b % 1024, swz = sb ^ (((sb >> 9) & 1) << 5); R = (st >> 1) * 16 + swz / 64; C = (st & 1) * 32 + (swz % 64) / 2; }
__host__ __device__ __forceinline__ int perm32(int rho) { const int n = rho >> 4, i = rho & 15; return 8 * (i >> 2) + 4 * n + (i & 3); }

struct Unit { int pm, pn; };
struct Gemm { const bf16_t* A; const bf16_t* Bt; int lda, ldb, M, N, K; };

struct StaticOrder {
    int nM, nN, nwg, G, c;
    __device__ void init(int M, int N, int G_, int c_) { nM = M / BM; nN = N / BM; nwg = nM * nN; G = G_; c = c_; }
    __device__ bool next(int i, Unit& u) const {
        const long L = (long)i * G + c; if (L >= nwg) return false;
        int wgid = (int)L; { const int q = nwg / NXCD, r = nwg % NXCD, xcd = wgid % NXCD, off = wgid / NXCD; wgid = (xcd < r ? xcd * (q + 1) : r * (q + 1) + (xcd - r) * q) + off; }
        const int nig = WGM * nN, gid = wgid / nig, fm = gid * WGM, gsz = (nM - fm) < WGM ? (nM - fm) : WGM;
        u.pm = fm + ((wgid % nig) % gsz); u.pn = (wgid % nig) / gsz; return true;
    }
};

__device__ __forceinline__ unsigned cvt_pk_bf16(float lo, float hi) { unsigned r; asm volatile("v_cvt_pk_bf16_f32 %0, %1, %2" : "=v"(r) : "v"(lo), "v"(hi)); return r; }

typedef f32x4 Acc[2][2][4][2];

struct EpiF32 {
    static constexpr bool PERM = false, MID = false;
    float* C; int ldc;
    __device__ __forceinline__ void operator()(const Acc& acc, const Unit& u, int wr, int wc, int fr, int fq) const {
        const int row0 = u.pm * BM + wr * 64 + fr, col0 = u.pn * BM + wc * 32 + 4 * fq;
#pragma unroll
        for (int ai = 0; ai < 2; ++ai)
#pragma unroll
            for (int m = 0; m < 4; ++m) { float* rowp = C + (size_t)(row0 + ai * HALF + m * 16) * ldc + col0;
#pragma unroll
                for (int bj = 0; bj < 2; ++bj)
#pragma unroll
                    for (int n = 0; n < 2; ++n) *(f32x4*)(rowp + bj * HALF + n * 16) = acc[ai][bj][m][n]; }
    }
};
struct EpiSwiGLU {
    static constexpr bool PERM = true, MID = false;
    bf16_t* O; int ldo;
    __device__ __forceinline__ void operator()(const Acc& acc, const Unit& u, int wr, int wc, int fr, int fq) const {
        const int row0 = u.pm * BM + wr * 64 + fr, col0 = u.pn * HALF + wc * 32 + 8 * fq;
#pragma unroll
        for (int ai = 0; ai < 2; ++ai)
#pragma unroll
            for (int m = 0; m < 4; ++m) { bf16_t* rowp = O + (size_t)(row0 + ai * HALF + m * 16) * ldo + col0;
                f32x4 v0, v1;
#pragma unroll
                for (int j = 0; j < 4; ++j) { v0[j] = siluf_(acc[ai][0][m][0][j]) * acc[ai][1][m][0][j]; v1[j] = siluf_(acc[ai][0][m][1][j]) * acc[ai][1][m][1][j]; }
                u32x4 w; w.x = cvt_pk_bf16(v0[0], v0[1]); w.y = cvt_pk_bf16(v0[2], v0[3]); w.z = cvt_pk_bf16(v1[0], v1[1]); w.w = cvt_pk_bf16(v1[2], v1[3]);
                *(u32x4*)rowp = w; }
    }
};
struct EpiGLU {
    static constexpr bool PERM = true, MID = false;
    bf16_t* O; int ldo; const float* bias;
    __device__ __forceinline__ void operator()(const Acc& acc, const Unit& u, int wr, int wc, int fr, int fq) const {
        const int row0 = u.pm * BM + wr * 64 + fr, col0 = u.pn * HALF + wc * 32 + 8 * fq;
        const f32x4 b10 = *(const f32x4*)(bias + col0), b11 = *(const f32x4*)(bias + col0 + 4), b20 = *(const f32x4*)(bias + 512 + col0), b21 = *(const f32x4*)(bias + 512 + col0 + 4);
#pragma unroll
        for (int ai = 0; ai < 2; ++ai)
#pragma unroll
            for (int m = 0; m < 4; ++m) { bf16_t* rowp = O + (size_t)(row0 + ai * HALF + m * 16) * ldo + col0;
                f32x4 v0, v1;
#pragma unroll
                for (int j = 0; j < 4; ++j) { v0[j] = (acc[ai][0][m][0][j] + b10[j]) * sigmoidf_(acc[ai][1][m][0][j] + b20[j]); v1[j] = (acc[ai][0][m][1][j] + b11[j]) * sigmoidf_(acc[ai][1][m][1][j] + b21[j]); }
                u32x4 w; w.x = cvt_pk_bf16(v0[0], v0[1]); w.y = cvt_pk_bf16(v0[2], v0[3]); w.z = cvt_pk_bf16(v1[0], v1[1]); w.w = cvt_pk_bf16(v1[2], v1[3]);
                *(u32x4*)rowp = w; }
    }
};
struct EpiProj {
    static constexpr bool PERM = true, MID = false;
    bf16_t* O; int ldo;
    __device__ __forceinline__ void operator()(const Acc& acc, const Unit& u, int wr, int wc, int fr, int fq) const {
        const int row0 = u.pm * BM + wr * 64 + fr, col0 = u.pn * BM + wc * 32 + 8 * fq;
        const int pn = u.pn;
        const int act = (pn < 2) ? 0 : (pn < 4) ? 1 : (pn < 10) ? 0 : (pn < 12) ? 2 : (pn < 14) ? 1 : 3;
#pragma unroll
        for (int ai = 0; ai < 2; ++ai)
#pragma unroll
            for (int m = 0; m < 4; ++m) { bf16_t* rowp = O + (size_t)(row0 + ai * HALF + m * 16) * ldo + col0;
#pragma unroll
                for (int bj = 0; bj < 2; ++bj) { f32x4 v0 = acc[ai][bj][m][0], v1 = acc[ai][bj][m][1];
                    if (act == 1) {
#pragma unroll
                        for (int j = 0; j < 4; ++j) { v0[j] = geluf_(v0[j]); v1[j] = geluf_(v1[j]); } }
                    else if (act == 2) {
#pragma unroll
                        for (int j = 0; j < 4; ++j) { v0[j] = siluf_(v0[j]); v1[j] = siluf_(v1[j]); } }
                    else if (act == 3) {
#pragma unroll
                        for (int j = 0; j < 4; ++j) { v0[j] = sigmoidf_(v0[j]); v1[j] = sigmoidf_(v1[j]); } }
                    u32x4 w; w.x = cvt_pk_bf16(v0[0], v0[1]); w.y = cvt_pk_bf16(v0[2], v0[3]); w.z = cvt_pk_bf16(v1[0], v1[1]); w.w = cvt_pk_bf16(v1[2], v1[3]);
                    *(u32x4*)(rowp + bj * HALF) = w; } }
    }
};
struct EpiMerge {
    static constexpr bool PERM = false, MID = true;
    bf16_t* O; int ldo; const bf16_t* gates; int ldg;
    __device__ __forceinline__ void mid(Acc& acc, const Unit& u, int t, int wr, int wc, int fr, int fq) const {
        if (t != 8 && t != 16) return;
        const int nb = t >> 3;
        const int row0 = u.pm * BM + wr * 64 + fr, col0 = u.pn * BM + wc * 32 + 4 * fq;
#pragma unroll
        for (int ai = 0; ai < 2; ++ai)
#pragma unroll
            for (int m = 0; m < 4; ++m) { const bf16_t* gp = gates + (size_t)(row0 + ai * HALF + m * 16) * ldg + col0;
#pragma unroll
                for (int bj = 0; bj < 2; ++bj)
#pragma unroll
                    for (int n = 0; n < 2; ++n) {
                        const u32x2 a = *(const u32x2*)(gp + (nb - 1) * 1024 + bj * HALF + n * 16), b = *(const u32x2*)(gp + nb * 1024 + bj * HALF + n * 16);
                        f32x4 r;
                        r[0] = __uint_as_float(a.x << 16) / __uint_as_float(b.x << 16); r[1] = __uint_as_float(a.x & 0xffff0000u) / __uint_as_float(b.x & 0xffff0000u);
                        r[2] = __uint_as_float(a.y << 16) / __uint_as_float(b.y << 16); r[3] = __uint_as_float(a.y & 0xffff0000u) / __uint_as_float(b.y & 0xffff0000u);
                        acc[ai][bj][m][n] = acc[ai][bj][m][n] * r; }
                asm volatile("" ::: "memory"); }
    }
    __device__ __forceinline__ void operator()(const Acc& acc, const Unit& u, int wr, int wc, int fr, int fq) const {
        const int row0 = u.pm * BM + wr * 64 + fr, col0 = u.pn * BM + wc * 32 + 4 * fq;
#pragma unroll
        for (int ai = 0; ai < 2; ++ai)
#pragma unroll
            for (int m = 0; m < 4; ++m) { const size_t r = (size_t)(row0 + ai * HALF + m * 16); const bf16_t* gp = gates + r * ldg + 2048 + col0; bf16_t* op = O + r * ldo + col0;
#pragma unroll
                for (int bj = 0; bj < 2; ++bj)
#pragma unroll
                    for (int n = 0; n < 2; ++n) {
                        const u32x2 a = *(const u32x2*)(gp + bj * HALF + n * 16);
                        const f32x4 v = acc[ai][bj][m][n];
                        u32x2 w; w.x = cvt_pk_bf16(v[0] * __uint_as_float(a.x << 16), v[1] * __uint_as_float(a.x & 0xffff0000u));
                        w.y = cvt_pk_bf16(v[2] * __uint_as_float(a.y << 16), v[3] * __uint_as_float(a.y & 0xffff0000u));
                        *(u32x2*)(op + bj * HALF + n * 16) = w; } }
    }
};

template <class Epi>
__device__ __forceinline__ void gemm_phase(LAS unsigned char* lds, const Gemm g, const StaticOrder& S, const Epi& E) {
    const int tid = otid(), wid = __builtin_amdgcn_readfirstlane(tid >> 6), lane = tid & 63, wr = wid >> 2, wc = wid & 3, fr = lane & 15, fq = lane >> 4;
    const int K = g.K, nt = K / BK;
    unsigned voffA[2], voffB[2];
#pragma unroll
    for (int i = 0; i < 2; ++i) { int R, C; stage_rc(tid * 16 + i * 8192, R, C); const int Rb = Epi::PERM ? ((R & ~31) + perm32(R & 31)) : R;
        voffA[i] = (unsigned)(R * g.lda + C) * 2u; voffB[i] = (unsigned)(Rb * g.ldb + C) * 2u; }
    const size_t kstep = (size_t)(BK * 2);
    const size_t hstepA = (size_t)HALF * g.lda * 2, hstepB = (size_t)HALF * g.ldb * 2;
    const size_t tstepA = 2 * hstepA, tstepB = 2 * hstepB;
    const unsigned ldsw = (unsigned)wid * 1024u;
    const int aoff = lds_byte(wr * 64 + fr, fq * 8), boff = lds_byte(wc * 32 + fr, fq * 8);
#define PG8_SA(b, h) (((b) * 2 + (h)) * HTB)
#define PG8_SB(b, h) ((4 + (b) * 2 + (h)) * HTB)
#define PG8_STAGE(bufoff, gbase, voff) do { _Pragma("unroll") for (int _i = 0; _i < 2; ++_i) \
        __builtin_amdgcn_global_load_lds((const unsigned*)((const char*)(gbase) + (voff)[_i]), (LAS unsigned*)(lds + (bufoff) + ldsw + _i * 8192), 16, 0, 0); } while (0)
#define PG8_LDA(dst, b, h) do { _Pragma("unroll") for (int m = 0; m < 4; ++m) _Pragma("unroll") for (int k = 0; k < 2; ++k) dst[m][k] = *(const LAS bf16x8*)(lds + PG8_SA(b, h) + aoff + m * 2048 + k * 1024); } while (0)
#define PG8_LDB(dst, b, h) do { _Pragma("unroll") for (int n = 0; n < 2; ++n) _Pragma("unroll") for (int k = 0; k < 2; ++k) dst[n][k] = *(const LAS bf16x8*)(lds + PG8_SB(b, h) + boff + n * 2048 + k * 1024); } while (0)
#define PG8_MMA(ai, bj, At, Bt) do { __builtin_amdgcn_s_setprio(1); _Pragma("unroll") for (int m = 0; m < 4; ++m) _Pragma("unroll") for (int n = 0; n < 2; ++n) _Pragma("unroll") for (int k = 0; k < 2; ++k) \
        acc[ai][bj][m][n] = __builtin_amdgcn_mfma_f32_16x16x32_bf16(Bt[n][k], At[m][k], acc[ai][bj][m][n], 0, 0, 0); __builtin_amdgcn_s_setprio(0); } while (0)
#define PG8_WAIT_V(n) asm volatile("s_waitcnt vmcnt(" #n ")" ::: "memory")
#define PG8_WAIT_L(n) asm volatile("s_waitcnt lgkmcnt(" #n ")" ::: "memory")
#define PG8_BAR __builtin_amdgcn_s_barrier()
#define PG8_SCHED __builtin_amdgcn_sched_barrier(0)
    Unit cur, nxt; int ui = 0;
    if (!S.next(0, cur)) return;
    Acc acc;
#pragma unroll
    for (int a = 0; a < 2; ++a)
#pragma unroll
        for (int b = 0; b < 2; ++b)
#pragma unroll
            for (int m = 0; m < 4; ++m)
#pragma unroll
                for (int n = 0; n < 2; ++n) acc[a][b][m][n] = (f32x4){0.f, 0.f, 0.f, 0.f};
    bf16x8 At[4][2], B0[2][2], B1[2][2];
    const char* cA = (const char*)g.A + (size_t)cur.pm * tstepA; const char* cB = (const char*)g.Bt + (size_t)cur.pn * tstepB;
    PG8_STAGE(PG8_SB(0, 0), cB, voffB); PG8_STAGE(PG8_SA(0, 0), cA, voffA); PG8_STAGE(PG8_SB(0, 1), cB + hstepB, voffB); PG8_STAGE(PG8_SA(0, 1), cA + hstepA, voffA);
    if (wr == 1) PG8_BAR;
    PG8_WAIT_V(4); PG8_BAR;
    PG8_STAGE(PG8_SB(1, 0), cB + kstep, voffB); PG8_STAGE(PG8_SA(1, 0), cA + kstep, voffA); PG8_STAGE(PG8_SB(1, 1), cB + hstepB + kstep, voffB);
    PG8_WAIT_V(6); PG8_BAR;
    for (;;) {
        const bool has_next = S.next(ui + 1, nxt);
        const char* nA = has_next ? (const char*)g.A + (size_t)nxt.pm * tstepA : cA; const char* nB = has_next ? (const char*)g.Bt + (size_t)nxt.pn * tstepB : cB;
        for (int t = 0; t < nt; t += 2) {
            const bool last = (t == nt - 2);
            const char* a1 = cA + (size_t)(t + 1) * kstep;
            const char* a2 = last ? nA : cA + (size_t)(t + 2) * kstep; const char* b2 = last ? nB : cB + (size_t)(t + 2) * kstep;
            const char* a3 = a2 + kstep; const char* b3 = b2 + kstep;
            if constexpr (Epi::MID) E.mid(acc, cur, t, wr, wc, fr, fq);
            PG8_LDB(B0, 0, 0); PG8_SCHED; PG8_LDA(At, 0, 0); PG8_STAGE(PG8_SA(1, 1), a1 + hstepA, voffA);
            PG8_WAIT_L(8); PG8_BAR; PG8_WAIT_L(0); PG8_MMA(0, 0, At, B0); PG8_BAR; PG8_SCHED;
            PG8_LDB(B1, 0, 1); PG8_STAGE(PG8_SB(0, 0), b2, voffB);
            PG8_BAR; PG8_WAIT_L(0); PG8_MMA(0, 1, At, B1); PG8_BAR;
            PG8_LDA(At, 0, 1); PG8_STAGE(PG8_SA(0, 0), a2, voffA);
            PG8_BAR; PG8_WAIT_L(0); PG8_MMA(1, 0, At, B0); PG8_BAR; PG8_SCHED;
            PG8_STAGE(PG8_SB(0, 1), b2 + hstepB, voffB);
            PG8_WAIT_V(6); PG8_BAR; PG8_MMA(1, 1, At, B1); PG8_BAR;
            PG8_LDB(B0, 1, 0); PG8_SCHED; PG8_LDA(At, 1, 0); PG8_STAGE(PG8_SA(0, 1), a2 + hstepA, voffA);
            PG8_WAIT_L(8); PG8_BAR; PG8_WAIT_L(0); PG8_MMA(0, 0, At, B0); PG8_BAR; PG8_SCHED;
            PG8_LDB(B1, 1, 1); PG8_STAGE(PG8_SB(1, 0), b3, voffB);
            PG8_BAR; PG8_WAIT_L(0); PG8_MMA(0, 1, At, B1); PG8_BAR;
            PG8_LDA(At, 1, 1); PG8_STAGE(PG8_SA(1, 0), a3, voffA);
            PG8_BAR; PG8_WAIT_L(0); PG8_MMA(1, 0, At, B0); PG8_BAR; PG8_SCHED;
            PG8_STAGE(PG8_SB(1, 1), b3 + hstepB, voffB);
            PG8_WAIT_V(6); PG8_BAR; PG8_MMA(1, 1, At, B1); PG8_BAR;
        }
        E(acc, cur, wr, wc, fr, fq);
        if (!has_next) break;
#pragma unroll
        for (int a = 0; a < 2; ++a)
#pragma unroll
            for (int b = 0; b < 2; ++b)
#pragma unroll
                for (int m = 0; m < 4; ++m)
#pragma unroll
                    for (int n = 0; n < 2; ++n) acc[a][b][m][n] = (f32x4){0.f, 0.f, 0.f, 0.f};
        cur = nxt; cA = nA; cB = nB; ++ui;
    }
    PG8_WAIT_V(0);
    if (wr == 0) PG8_BAR;
    PG8_BAR;
#undef PG8_SA
#undef PG8_SB
#undef PG8_STAGE
#undef PG8_LDA
#undef PG8_LDB
#undef PG8_MMA
#undef PG8_WAIT_V
#undef PG8_WAIT_L
#undef PG8_BAR
#undef PG8_SCHED
}
}

struct Args {
    const float* x_prompt; const float* x_sample; const float* state_hgrn; const float* state_re; const float* state_im;
    const float* norm_g; const float* w_gate; const float* w_up; const float* w_down; const float* w_in;
    const float* lb_logits; const float* hgrn_ng; const float* gmlp_ws; const float* gmlp_bs; const float* gmlp_ng; const float* gmlp_nb;
    const float* lam_re; const float* lam_im; const float* log_dt; const float* b_re; const float* b_im; const float* c_re; const float* c_im; const float* s5_d;
    const float* glu_w; const float* glu_b; const float* w_branch; const float* w_out;
    float* out; unsigned char* ws;
    int ph_lo, ph_hi;
};

struct Ctx {
    LAS unsigned char* lds;
    int l;
    float* X;
    bf16_t* H; bf16_t* PROJ; bf16_t* ACT; float* Y; bf16_t* W; bf16_t* DS; float* DEC; float* E;
    float* LB; float* ABAR; float* A128; bf16_t* BBAR; bf16_t* CCT;
};

__device__ __forceinline__ void transpose_item(const float* src, int src_pitch, int src_c0, int k0, bf16_t* dst, int dst_pitch, int dst_r0, int dst_c0, LAS float* scr, int lane) {
#pragma unroll 8
    for (int i = 0; i < 32; ++i) { const int kk = 2 * i + (lane >> 5); scr[kk * 33 + (lane & 31)] = src[(size_t)(k0 + kk) * src_pitch + src_c0 + (lane & 31)]; }
    LDS_WAIT();
    const int c = lane & 7;
#pragma unroll
    for (int j = 0; j < 4; ++j) { const int n = (lane >> 3) + 8 * j; const LAS float* s = scr + (8 * c) * 33 + n;
        u32x4 o; o.x = pk2(s[0 * 33], s[1 * 33]); o.y = pk2(s[2 * 33], s[3 * 33]); o.z = pk2(s[4 * 33], s[5 * 33]); o.w = pk2(s[6 * 33], s[7 * 33]);
        *(u32x4*)(dst + (size_t)(dst_r0 + n) * dst_pitch + dst_c0 + k0 + 8 * c) = o; }
    LDS_WAIT();
}

__device__ __forceinline__ void phase_weights(const Args& A, const Ctx& C) {
    const int tid = otid(), lane = tid & 63, wave = tid >> 6, l = C.l;
    LAS float* scr = (LAS float*)(C.lds + wave * 16384);
    const int gw = blockIdx.x * 8 + wave, NGW = gridDim.x * 8;
    const Args& a = A;
    constexpr int I_GU = 16 * 176, I_D = 44 * 32, I_IN = 16 * 208, I_GLU = 8 * 32, I_BR = 8 * 32, I_OUT = 16 * 32;
    constexpr int NITEMS = 2 * I_GU + 2 * I_D + I_IN + I_GLU + 3 * I_BR + I_OUT;
    for (int it = gw; it < NITEMS; it += NGW) {
        int r = it;
        if (r < 2 * I_GU) {
            const int f = r / I_GU; r -= f * I_GU;
            const int kb = r / 176, nb = r % 176, n0 = nb * 32, pn = n0 >> 8, within = n0 & 255;
            const float* src = (within < 128 ? a.w_gate : a.w_up) + (size_t)(l * 2 + f) * DM * FF;
            transpose_item(src, FF, pn * 128 + (within & 127), kb * 64, C.W + (f ? W_GU1 : W_GU0), DM, n0, 0, scr, lane); continue; }
        r -= 2 * I_GU;
        if (r < 2 * I_D) {
            const int f = r / I_D; r -= f * I_D;
            const int kb = r / 32, nb = r % 32;
            transpose_item(a.w_down + (size_t)(l * 2 + f) * FF * DM, DM, nb * 32, kb * 64, C.W + (f ? W_D1 : W_D0), FF, nb * 32, 0, scr, lane); continue; }
        r -= 2 * I_D;
        if (r < I_IN) {
            const int kb = r / 208, nb = r % 208, n0 = nb * 32, blk = n0 >> 9;
            const int srcblk = (blk == 0) ? 0 : (blk == 1) ? 4 : (blk == 2) ? 6 : (blk == 3) ? 1 : (blk == 4) ? 2 : (blk == 5) ? 3 : (blk == 6) ? 5 : blk;
            transpose_item(a.w_in + (size_t)l * DM * NIN, NIN, srcblk * 512 + (n0 & 511), kb * 64, C.W + W_IN, DM, n0, 0, scr, lane); continue; }
        r -= I_IN;
        if (r < I_GLU) {
            const int kb = r / 32, nb = r % 32, n0 = nb * 32, pn = n0 >> 8, within = n0 & 255;
            transpose_item(a.glu_w + (size_t)l * 512 * 1024, 1024, (within < 128 ? 0 : 512) + pn * 128 + (within & 127), kb * 64, C.W + W_GLU, 512, n0, 0, scr, lane); continue; }
        r -= I_GLU;
        if (r < 3 * I_BR) {
            const int n = r / I_BR; r -= n * I_BR;
            const int kb = r / 32, nb = r % 32;
            transpose_item(a.w_branch + (size_t)(l * 3 + n) * 512 * 1024, 1024, nb * 32, kb * 64, C.W + W_BR, 1536, nb * 32, n * 512, scr, lane); continue; }
        r -= 3 * I_BR;
        { const int kb = r / 32, nb = r % 32;
          transpose_item(a.w_out + (size_t)l * DM * DM, DM, nb * 32, kb * 64, C.W + W_OUT, DM, nb * 32, 0, scr, lane); }
    }
    if (blockIdx.x == 0) {
        for (int i = tid; i < 512; i += 512) {
            float lb = 0.f;
            if (l > 0) {
                float mx = a.lb_logits[i];
                for (int j = 1; j < DEPTH; ++j) mx = fmaxf(mx, a.lb_logits[j * 512 + i]);
                float den = 0.f, num = 0.f;
                for (int j = 0; j < DEPTH; ++j) { const float e = __expf(a.lb_logits[j * 512 + i] - mx); den += e; if (j >= 1 && j <= l) num += e; }
                lb = num / den;
            }
            C.LB[i] = lb;
        }
    }
    if (blockIdx.x >= 1 && blockIdx.x <= 4) {
        const int idx = (blockIdx.x - 1) * 512 + tid;
        const int g = idx >> 6, p = idx & 63;
        const float lr = a.lam_re[(size_t)l * 2048 + idx], li = a.lam_im[(size_t)l * 2048 + idx];
        const float dt = expf(a.log_dt[l * 32 + g]);
        const float er = expf(lr * dt);
        float sn, cs; sincosf(li * dt, &sn, &cs);
        const float ar = er * cs, ai = er * sn;
        C.ABAR[idx * 2] = ar; C.ABAR[idx * 2 + 1] = ai;
        float pr = ar, pi = ai;
#pragma unroll
        for (int s = 0; s < 7; ++s) { const float nr = pr * pr - pi * pi, ni = 2.f * pr * pi; pr = nr; pi = ni; }
        C.A128[idx * 2] = pr; C.A128[idx * 2 + 1] = pi;
        const float den = lr * lr + li * li;
        const float cr = ((ar - 1.f) * lr + ai * li) / den, ci = (ai * lr - (ar - 1.f) * li) / den;
        const float* bre = a.b_re + ((size_t)l * 2048 + idx) * 16; const float* bim = a.b_im + ((size_t)l * 2048 + idx) * 16;
#pragma unroll
        for (int j = 0; j < 16; ++j) {
            const float br = bre[j], bi = bim[j];
            C.BBAR[((size_t)g * 128 + p) * 16 + j] = (bf16_t)f2bf(cr * br - ci * bi);
            C.BBAR[((size_t)g * 128 + 64 + p) * 16 + j] = (bf16_t)f2bf(cr * bi + ci * br);
        }
#pragma unroll
        for (int i = 0; i < 16; ++i) {
            C.CCT[((size_t)g * 16 + i) * 128 + p] = (bf16_t)f2bf(a.c_re[(((size_t)l * 32 + g) * 16 + i) * 64 + p]);
            C.CCT[((size_t)g * 16 + i) * 128 + 64 + p] = (bf16_t)f2bf(-a.c_im[(((size_t)l * 32 + g) * 16 + i) * 64 + p]);
        }
    }
}

__device__ __forceinline__ void phase_norm(const Args& A, const Ctx& C, int mode, float scale, const float* ga, const float* gb) {
    const int tid = otid(), lane = tid & 63, wave = tid >> 6;
    const int gw = blockIdx.x * 8 + wave, NGW = gridDim.x * 8;
    for (int row = gw; row < MREAL; row += NGW) {
        float* xr = C.X + (size_t)row * DM;
        f32x4 x[4];
        if (mode == 0) {
            const float* src = row < MP ? A.x_prompt + (size_t)row * DM : A.x_sample + (size_t)(row - MP) * DM;
#pragma unroll
            for (int j = 0; j < 4; ++j) x[j] = *(const f32x4*)(src + 256 * j + 4 * lane);
        } else {
            const float* yr = C.Y + (size_t)row * DM;
            f32x4 y[4]; float ss = 0.f;
#pragma unroll
            for (int j = 0; j < 4; ++j) { y[j] = *(const f32x4*)(yr + 256 * j + 4 * lane); ss += y[j][0] * y[j][0] + y[j][1] * y[j][1] + y[j][2] * y[j][2] + y[j][3] * y[j][3]; }
            const float rstd = rsqrtf(wave_sum(ss) * (1.f / DM) + EPS) * scale;
#pragma unroll
            for (int j = 0; j < 4; ++j) { const f32x4 g = *(const f32x4*)(ga + 256 * j + 4 * lane); const f32x4 xo = *(const f32x4*)(xr + 256 * j + 4 * lane); x[j] = xo + y[j] * g * rstd; }
        }
#pragma unroll
        for (int j = 0; j < 4; ++j) *(f32x4*)(xr + 256 * j + 4 * lane) = x[j];
        if (gb) {
            float ss = 0.f;
#pragma unroll
            for (int j = 0; j < 4; ++j) ss += x[j][0] * x[j][0] + x[j][1] * x[j][1] + x[j][2] * x[j][2] + x[j][3] * x[j][3];
            const float rstd = rsqrtf(wave_sum(ss) * (1.f / DM) + EPS);
            bf16_t* hr = C.H + (size_t)row * DM;
#pragma unroll
            for (int j = 0; j < 4; ++j) { const f32x4 g = *(const f32x4*)(gb + 256 * j + 4 * lane); const f32x4 v = x[j] * g * rstd;
                u32x2 w; w.x = pk2(v[0], v[1]); w.y = pk2(v[2], v[3]); *(u32x2*)(hr + 256 * j + 4 * lane) = w; }
        }
    }
}

#define MFMA16(a, b, c) __builtin_amdgcn_mfma_f32_16x16x32_bf16((a), (b), (c), 0, 0, 0)

__device__ __forceinline__ void sig2(float z, float& sp, float& sn) { const float e = __expf(-fabsf(z)); const float r = 1.0f / (1.0f + e); const float er = e * r; sp = z >= 0.f ? r : er; sn = z >= 0.f ? er : r; }

__device__ __forceinline__ void hgrn_passA(const Args& A, const Ctx& C, int pair) {
    const int tid = otid(), half = tid >> 8, t4 = tid & 255, ch = t4 & 127, th = t4 >> 7, lane = tid & 63, w4 = (tid >> 6) & 3;
    const int h = pair & 3, tile = (pair >> 2) & 15, b = pair >> 6;
    const int c = tile * 2 + half, item = ((b * 32 + c) << 2) + h;
    const size_t row0 = (size_t)b * SEQ + (size_t)c * 64;
    LAS unsigned char* L = C.lds + half * 65536;
    LAS bf16_t* kT = (LAS bf16_t*)L; LAS bf16_t* vT = (LAS bf16_t*)(L + 18432); LAS float* xch = (LAS float*)(L + 36864);
    const float lb = C.LB[h * 128 + ch], oml = 1.f - lb;
    float bl[32], kk[32]; unsigned vv[16];
    const bf16_t* pz = C.PROJ + (row0 + 32 * th) * NIN + C_XF + h * 128 + ch;
    const bf16_t* pv = C.PROJ + (row0 + 32 * th) * NIN + C_XI + h * 128 + ch;
    float cum = 0.f;
#pragma unroll
    for (int i = 0; i < 32; ++i) {
        const float z = bf2f(pz[(size_t)i * NIN]); float sp, sn; sig2(z, sp, sn);
        const float f = lb + oml * sp; cum += __logf(f); bl[i] = cum; kk[i] = oml * sn;
        const unsigned raw = pv[(size_t)i * NIN];
        if (i & 1) vv[i >> 1] |= raw << 16; else vv[i >> 1] = raw;
    }
    xch[th * 128 + ch] = cum;
    __syncthreads();
    const float tot0 = xch[ch], tot1 = xch[128 + ch], blast = tot0 + tot1, off = th ? tot0 : 0.f;
    unsigned kp[16];
#pragma unroll
    for (int i = 0; i < 32; i += 2) kp[i >> 1] = pk2(kk[i] * __expf(blast - (bl[i] + off)), kk[i + 1] * __expf(blast - (bl[i + 1] + off)));
#pragma unroll
    for (int q = 0; q < 4; ++q) {
        *(LAS u32x4*)(kT + ch * 72 + 32 * th + 8 * q) = (u32x4){kp[4 * q], kp[4 * q + 1], kp[4 * q + 2], kp[4 * q + 3]};
        *(LAS u32x4*)(vT + ch * 72 + 32 * th + 8 * q) = (u32x4){vv[4 * q], vv[4 * q + 1], vv[4 * q + 2], vv[4 * q + 3]};
    }
    if (th == 0) { C.DEC[(size_t)item * 256 + ch] = __expf(blast); C.DEC[(size_t)item * 256 + 128 + ch] = tot0; }
    __syncthreads();
    f32x4 acc[2][8];
#pragma unroll
    for (int i = 0; i < 2; ++i)
#pragma unroll
        for (int j = 0; j < 8; ++j) acc[i][j] = (f32x4){0.f, 0.f, 0.f, 0.f};
    const int fr = lane & 15, fq = lane >> 4;
#pragma unroll
    for (int s = 0; s < 2; ++s) {
        bf16x8 af[2];
#pragma unroll
        for (int i = 0; i < 2; ++i) af[i] = *(const LAS bf16x8*)(vT + (32 * w4 + 16 * i + fr) * 72 + 32 * s + 8 * fq);
#pragma unroll
        for (int j = 0; j < 8; ++j) { const bf16x8 bfr = *(const LAS bf16x8*)(kT + (16 * j + fr) * 72 + 32 * s + 8 * fq);
#pragma unroll
            for (int i = 0; i < 2; ++i) acc[i][j] = MFMA16(af[i], bfr, acc[i][j]); }
    }
    bf16_t* ds = C.DS + (size_t)item * 16384;
#pragma unroll
    for (int i = 0; i < 2; ++i)
#pragma unroll
        for (int j = 0; j < 8; ++j)
#pragma unroll
            for (int r = 0; r < 4; ++r) ds[(32 * w4 + 16 * i + 4 * fq + r) * 128 + 16 * j + fr] = (bf16_t)f2bf(acc[i][j][r]);
    __syncthreads();
}

__device__ __forceinline__ void hgrn_passB(const Args& A, const Ctx& C) {
    for (int gid = blockIdx.x * 512 + otid(); gid < 131072; gid += gridDim.x * 512) {
        const int bh = gid >> 12, b = bh >> 2, h = bh & 3, v = (gid >> 5) & 127, k4 = (gid & 31) * 4;
        float s[4] = {0.f, 0.f, 0.f, 0.f};
        for (int c = 0; c < 32; ++c) {
            const int item = ((b * 32 + c) << 2) + h;
            u32x2* p = (u32x2*)(C.DS + (size_t)item * 16384 + v * 128 + k4);
            const u32x2 raw = *p;
            const f32x4 dec = *(const f32x4*)(C.DEC + (size_t)item * 256 + k4), bm = *(const f32x4*)(C.DEC + (size_t)item * 256 + 128 + k4);
            const float d0 = __uint_as_float(raw.x << 16), d1 = __uint_as_float(raw.x & 0xffff0000u), d2 = __uint_as_float(raw.y << 16), d3 = __uint_as_float(raw.y & 0xffff0000u);
            u32x2 w; w.x = pk2(s[0] * __expf(bm[0]), s[1] * __expf(bm[1])); w.y = pk2(s[2] * __expf(bm[2]), s[3] * __expf(bm[3]));
            *p = w;
            s[0] = dec[0] * s[0] + d0; s[1] = dec[1] * s[1] + d1; s[2] = dec[2] * s[2] + d2; s[3] = dec[3] * s[3] + d3;
        }
        float* o = A.out + O_HGP + ((size_t)(C.l * NB + b) * 4 + h) * 16384;
#pragma unroll
        for (int j = 0; j < 4; ++j) o[(k4 + j) * 128 + v] = s[j];
    }
}

__device__ __forceinline__ void hgrn_passC(const Args& A, const Ctx& C, int pair) {
    const int tid = otid(), half = tid >> 8, t4 = tid & 255, ch = t4 & 127, th = t4 >> 7, lane = tid & 63, w4 = (tid >> 6) & 3;
    const int h = pair & 3, tile = (pair >> 2) & 15, b = pair >> 6;
    const int c = tile * 2 + half, item = ((b * 32 + c) << 2) + h;
    const size_t row0 = (size_t)b * SEQ + (size_t)c * 64;
    LAS unsigned char* L = C.lds + half * 65536;
    LAS bf16_t* QT = (LAS bf16_t*)L; LAS bf16_t* KT = (LAS bf16_t*)(L + 17408); LAS bf16_t* vT = (LAS bf16_t*)(L + 34816); LAS bf16_t* P = (LAS bf16_t*)(L + 53248); LAS float* xch = (LAS float*)(L + 62464);
    const float lb = C.LB[h * 128 + ch], oml = 1.f - lb;
    {
        float bl[32], kk[32], qq[32]; unsigned vv[16];
        const bf16_t* pz = C.PROJ + (row0 + 32 * th) * NIN + C_XF + h * 128 + ch;
        const bf16_t* pv = C.PROJ + (row0 + 32 * th) * NIN + C_XI + h * 128 + ch;
        const bf16_t* pq = C.PROJ + (row0 + 32 * th) * NIN + C_XQ + h * 128 + ch;
        float cum = 0.f;
#pragma unroll
        for (int i = 0; i < 32; ++i) {
            const float z = bf2f(pz[(size_t)i * NIN]); float sp, sn; sig2(z, sp, sn);
            const float f = lb + oml * sp; cum += __logf(f); bl[i] = cum; kk[i] = oml * sn;
            qq[i] = bf2f(pq[(size_t)i * NIN]);
            const unsigned raw = pv[(size_t)i * NIN];
            if (i & 1) vv[i >> 1] |= raw << 16; else vv[i >> 1] = raw;
        }
        xch[th * 128 + ch] = cum;
        __syncthreads();
        const float tot0 = xch[ch];
        const float off = th ? 0.f : tot0;
#pragma unroll
        for (int i = 0; i < 32; ++i) {
            const float rel = bl[i] - off;
            QT[(32 * th + i) * 136 + ch] = (bf16_t)f2bf(qq[i] * __expf(rel));
            KT[(32 * th + i) * 136 + ch] = (bf16_t)f2bf(kk[i] * __expf(-rel));
        }
#pragma unroll
        for (int q = 0; q < 4; ++q) *(LAS u32x4*)(vT + ch * 72 + 32 * th + 8 * q) = (u32x4){vv[4 * q], vv[4 * q + 1], vv[4 * q + 2], vv[4 * q + 3]};
    }
    __syncthreads();
    const int fr = lane & 15, fq = lane >> 4;
    {
        f32x4 sc[4];
#pragma unroll
        for (int j = 0; j < 4; ++j) sc[j] = (f32x4){0.f, 0.f, 0.f, 0.f};
#pragma unroll
        for (int s = 0; s < 4; ++s) {
            const bf16x8 af = *(const LAS bf16x8*)(QT + (16 * w4 + fr) * 136 + 32 * s + 8 * fq);
#pragma unroll
            for (int j = 0; j < 4; ++j) { const bf16x8 bfr = *(const LAS bf16x8*)(KT + (16 * j + fr) * 136 + 32 * s + 8 * fq); sc[j] = MFMA16(af, bfr, sc[j]); }
        }
#pragma unroll
        for (int j = 0; j < 4; ++j)
#pragma unroll
            for (int r = 0; r < 4; ++r) { const int t = 16 * w4 + 4 * fq + r, s = 16 * j + fr; P[t * 72 + s] = (bf16_t)f2bf(s <= t ? sc[j][r] : 0.f); }
    }
    __syncthreads();
    f32x4 o[8];
#pragma unroll
    for (int j = 0; j < 8; ++j) o[j] = (f32x4){0.f, 0.f, 0.f, 0.f};
#pragma unroll
    for (int s = 0; s < 2; ++s) {
        const bf16x8 af = *(const LAS bf16x8*)(P + (16 * w4 + fr) * 72 + 32 * s + 8 * fq);
#pragma unroll
        for (int j = 0; j < 8; ++j) { const bf16x8 bfr = *(const LAS bf16x8*)(vT + (16 * j + fr) * 72 + 32 * s + 8 * fq); o[j] = MFMA16(af, bfr, o[j]); }
    }
    const bf16_t* ds = C.DS + (size_t)item * 16384;
#pragma unroll
    for (int s = 0; s < 4; ++s) {
        const bf16x8 af = *(const LAS bf16x8*)(QT + (16 * w4 + fr) * 136 + 32 * s + 8 * fq);
#pragma unroll
        for (int j = 0; j < 8; ++j) { const bf16x8 bfr = *(const bf16x8*)(ds + (16 * j + fr) * 128 + 32 * s + 8 * fq); o[j] = MFMA16(af, bfr, o[j]); }
    }
#pragma unroll
    for (int r = 0; r < 4; ++r) {
        float ss = 0.f;
#pragma unroll
        for (int j = 0; j < 8; ++j) ss += o[j][r] * o[j][r];
        ss += __shfl_xor(ss, 1); ss += __shfl_xor(ss, 2); ss += __shfl_xor(ss, 4); ss += __shfl_xor(ss, 8);
        const float rstd = rsqrtf(ss * (1.f / 128.f) + EPS);
        const size_t t = row0 + 16 * w4 + 4 * fq + r;
        bf16_t* prow = C.PROJ + t * NIN;
#pragma unroll
        for (int j = 0; j < 8; ++j) { const int vc = h * 128 + 16 * j + fr; const float xg = bf2f(prow[C_XG + vc]);
            prow[C_XQ + vc] = (bf16_t)f2bf(o[j][r] * rstd * A.hgrn_ng[C.l * 512 + vc] * xg); }
    }
    __syncthreads();
}

__device__ __forceinline__ void gmlp_item(const Args& A, const Ctx& C, int T, int g) {
    const int tid = otid(), lane = tid & 63, w = tid >> 6, l = C.l;
    const size_t row0 = (size_t)T * 128;
    LAS bf16_t* WL = (LAS bf16_t*)C.lds; LAS bf16_t* vT = (LAS bf16_t*)(C.lds + 34816); LAS float* st = (LAS float*)(C.lds + 69632);
    {
        const int tok = tid >> 2, q4 = tid & 3;
        const bf16_t* p = C.PROJ + (row0 + tok) * NIN + C_GV + q4 * 128;
        float s = 0.f, s2 = 0.f;
#pragma unroll
        for (int i = 0; i < 16; ++i) { const u32x4 r = *(const u32x4*)(p + 8 * i);
            const unsigned ww[4] = {r.x, r.y, r.z, r.w};
#pragma unroll
            for (int j = 0; j < 4; ++j) { const float a0 = __uint_as_float(ww[j] << 16), a1 = __uint_as_float(ww[j] & 0xffff0000u); s += a0 + a1; s2 += a0 * a0 + a1 * a1; } }
        s += __shfl_xor(s, 1); s += __shfl_xor(s, 2); s2 += __shfl_xor(s2, 1); s2 += __shfl_xor(s2, 2);
        const float mu = s * (1.f / 512.f), var = fmaxf(s2 * (1.f / 512.f) - mu * mu, 0.f);
        if (q4 == 0) { st[tok * 2] = mu; st[tok * 2 + 1] = rsqrtf(var + EPS); }
        const float* wsrc = A.gmlp_ws + (size_t)(l * 4 + g) * 16384;
#pragma unroll
        for (int i = 0; i < 8; ++i) { const int idx4 = tid + 512 * i, t = idx4 >> 5, s4 = (idx4 & 31) * 4;
            const f32x4 wv = *(const f32x4*)(wsrc + t * 128 + s4);
            u32x2 o; o.x = pk2(s4 <= t ? wv[0] : 0.f, s4 + 1 <= t ? wv[1] : 0.f); o.y = pk2(s4 + 2 <= t ? wv[2] : 0.f, s4 + 3 <= t ? wv[3] : 0.f);
            *(LAS u32x2*)(WL + t * 136 + s4) = o; }
    }
    __syncthreads();
    {
        const int c = tid & 127, sq = tid >> 7;
        const float ng = A.gmlp_ng[l * 512 + g * 128 + c], nb = A.gmlp_nb[l * 512 + g * 128 + c];
        const bf16_t* p = C.PROJ + (row0 + 32 * sq) * NIN + C_GV + g * 128 + c;
        unsigned vp[16];
#pragma unroll
        for (int i = 0; i < 32; i += 2) {
            const float x0 = bf2f(p[(size_t)i * NIN]), x1 = bf2f(p[(size_t)(i + 1) * NIN]);
            const float m0 = st[(32 * sq + i) * 2], r0 = st[(32 * sq + i) * 2 + 1], m1 = st[(32 * sq + i + 1) * 2], r1 = st[(32 * sq + i + 1) * 2 + 1];
            vp[i >> 1] = pk2((x0 - m0) * r0 * ng + nb, (x1 - m1) * r1 * ng + nb);
        }
#pragma unroll
        for (int q = 0; q < 4; ++q) *(LAS u32x4*)(vT + c * 136 + 32 * sq + 8 * q) = (u32x4){vp[4 * q], vp[4 * q + 1], vp[4 * q + 2], vp[4 * q + 3]};
    }
    __syncthreads();
    const int fr = lane & 15, fq = lane >> 4;
    f32x4 acc[8];
#pragma unroll
    for (int j = 0; j < 8; ++j) acc[j] = (f32x4){0.f, 0.f, 0.f, 0.f};
    const int nks = (w >> 1) + 1;
    for (int s = 0; s < nks; ++s) {
        const bf16x8 af = *(const LAS bf16x8*)(WL + (16 * w + fr) * 136 + 32 * s + 8 * fq);
#pragma unroll
        for (int j = 0; j < 8; ++j) { const bf16x8 bfr = *(const LAS bf16x8*)(vT + (16 * j + fr) * 136 + 32 * s + 8 * fq); acc[j] = MFMA16(af, bfr, acc[j]); }
    }
#pragma unroll
    for (int r = 0; r < 4; ++r) {
        const int t = 16 * w + 4 * fq + r;
        const float bs = A.gmlp_bs[(l * 4 + g) * 128 + t];
        bf16_t* prow = C.PROJ + (row0 + t) * NIN + C_GU + g * 128;
#pragma unroll
        for (int j = 0; j < 8; ++j) { const int c = 16 * j + fr; const float u = bf2f(prow[c]); prow[c] = (bf16_t)f2bf(u * (acc[j][r] + bs)); }
    }
    __syncthreads();
}

template <int PASS>
__device__ __forceinline__ void s5_item(const Args& A, const Ctx& C, int b, int ts, int go) {
    const int tid = otid(), lane = tid & 63, w = tid >> 6, l = C.l;
    const int g = go * 8 + w, fr = lane & 15, fq = lane >> 4;
    const size_t row0 = (size_t)b * SEQ + (size_t)ts * 128;
    LAS float* BU = (LAS float*)(C.lds + w * 16384);
    LAS bf16_t* HB = (LAS bf16_t*)(C.lds + w * 16384 + 8704);
    const bf16x8 zero8 = (bf16x8){0, 0, 0, 0, 0, 0, 0, 0};
    bf16x8 bfrag[8];
#pragma unroll
    for (int i = 0; i < 8; ++i) bfrag[i] = (fq < 2) ? *(const bf16x8*)(C.BBAR + ((size_t)g * 128 + 16 * i + fr) * 16 + 8 * fq) : zero8;
    bf16x8 cfrag[4];
    if (PASS == 3) {
#pragma unroll
        for (int s = 0; s < 4; ++s) cfrag[s] = *(const bf16x8*)(C.CCT + ((size_t)g * 16 + fr) * 128 + 32 * s + 8 * fq);
    }
    const float ar = C.ABAR[(g * 64 + lane) * 2], ai = C.ABAR[(g * 64 + lane) * 2 + 1];
    float hr = 0.f, hi = 0.f;
    if (PASS == 3) {
        const float pr = C.A128[(g * 64 + lane) * 2], pi = C.A128[(g * 64 + lane) * 2 + 1];
        for (int c = 0; c < ts; ++c) {
            const f32x2 e = *(const f32x2*)(C.E + ((((size_t)b * 16 + c) * 32 + g) * 64 + lane) * 2);
            const float nr = pr * hr - pi * hi + e.x, ni = pr * hi + pi * hr + e.y; hr = nr; hi = ni;
        }
    }
    const float dsk = (PASS == 3) ? A.s5_d[l * 512 + g * 16 + fr] : 0.f;
    for (int sc = 0; sc < 8; ++sc) {
        const bf16_t* urow = C.PROJ + (row0 + 16 * sc + fr) * NIN + C_SU + g * 16;
        const bf16x8 af = (fq < 2) ? *(const bf16x8*)(urow + 8 * fq) : zero8;
#pragma unroll
        for (int i = 0; i < 8; ++i) { f32x4 acc = (f32x4){0.f, 0.f, 0.f, 0.f}; acc = MFMA16(af, bfrag[i], acc);
#pragma unroll
            for (int r = 0; r < 4; ++r) BU[(4 * fq + r) * 132 + 16 * i + fr] = acc[r]; }
        __syncthreads();
#pragma unroll
        for (int t = 0; t < 16; ++t) {
            const float re = BU[t * 132 + lane], im = BU[t * 132 + 64 + lane];
            const float nr = ar * hr - ai * hi + re, ni = ar * hi + ai * hr + im; hr = nr; hi = ni;
            if (PASS == 3) { HB[t * 136 + lane] = (bf16_t)f2bf(hr); HB[t * 136 + 64 + lane] = (bf16_t)f2bf(hi); }
        }
        __syncthreads();
        if (PASS == 3) {
            f32x4 y = (f32x4){0.f, 0.f, 0.f, 0.f};
#pragma unroll
            for (int s = 0; s < 4; ++s) { const bf16x8 hf = *(const LAS bf16x8*)(HB + fr * 136 + 32 * s + 8 * fq); y = MFMA16(hf, cfrag[s], y); }
#pragma unroll
            for (int r = 0; r < 4; ++r) {
                bf16_t* prow = C.PROJ + (row0 + 16 * sc + 4 * fq + r) * NIN;
                const float u = bf2f(prow[C_SU + g * 16 + fr]);
                prow[C_GV + g * 16 + fr] = (bf16_t)f2bf(geluf_(y[r] + dsk * u));
            }
            __syncthreads();
        }
    }
    if (PASS == 1) { *(f32x2*)(C.E + ((((size_t)b * 16 + ts) * 32 + g) * 64 + lane) * 2) = (f32x2){hr, hi}; }
    else if (ts == 15) { A.out[O_REP + ((size_t)(l * NB + b) * 32 + g) * 64 + lane] = hr; A.out[O_IMP + ((size_t)(l * NB + b) * 32 + g) * 64 + lane] = hi; }
}

__device__ __forceinline__ void sample_hgrn(const Args& A, const Ctx& C, int r, int h) {
    const int tid = otid(), v = tid & 127, kq = tid >> 7, l = C.l;
    bf16_t* prow = C.PROJ + (size_t)(MP + r) * NIN;
    LAS float* red = (LAS float*)C.lds;
    const float xi = bf2f(prow[C_XI + h * 128 + v]);
    const float* S0 = A.state_hgrn + (((size_t)l * MS + r) * 4 + h) * 16384;
    float* S1 = A.out + O_HGS + (((size_t)l * MS + r) * 4 + h) * 16384;
    float op = 0.f;
#pragma unroll 4
    for (int i = 0; i < 32; ++i) {
        const int k = 32 * kq + i;
        const float z = bf2f(prow[C_XF + h * 128 + k]), q = bf2f(prow[C_XQ + h * 128 + k]);
        const float lb = C.LB[h * 128 + k]; float sp, sn; sig2(z, sp, sn);
        const float f = lb + (1.f - lb) * sp, kk = (1.f - lb) * sn;
        const float sn1 = f * S0[k * 128 + v] + kk * xi;
        S1[k * 128 + v] = sn1; op += sn1 * q;
    }
    red[kq * 128 + v] = op;
    __syncthreads();
    float o = 0.f, ss = 0.f;
    if (tid < 128) { o = red[v] + red[128 + v] + red[256 + v] + red[384 + v]; ss = o * o; }
    ss = wave_sum(ss);
    if ((tid & 63) == 0) red[512 + (tid >> 6)] = ss;
    __syncthreads();
    if (tid < 128) {
        const float tot = red[512] + red[513];
        const float rstd = rsqrtf(tot * (1.f / 128.f) + EPS);
        const float xg = bf2f(prow[C_XG + h * 128 + v]);
        prow[C_XQ + h * 128 + v] = (bf16_t)f2bf(o * rstd * A.hgrn_ng[l * 512 + h * 128 + v] * xg);
    }
    __syncthreads();
}

__device__ __forceinline__ void sample_row(const Args& A, const Ctx& C, int r) {
    const int tid = otid(), lane = tid & 63, w = tid >> 6, l = C.l;
    bf16_t* prow = C.PROJ + (size_t)(MP + r) * NIN;
    LAS float* red = (LAS float*)C.lds;
    {
        const float x = bf2f(prow[C_GV + tid]);
        const float s = wave_sum(x), s2 = wave_sum(x * x);
        if (lane == 0) { red[w * 2] = s; red[w * 2 + 1] = s2; }
        __syncthreads();
        float ts = 0.f, ts2 = 0.f;
#pragma unroll
        for (int i = 0; i < 8; ++i) { ts += red[i * 2]; ts2 += red[i * 2 + 1]; }
        const float mu = ts * (1.f / 512.f), var = fmaxf(ts2 * (1.f / 512.f) - mu * mu, 0.f);
        const float v = (x - mu) * rsqrtf(var + EPS) * A.gmlp_ng[l * 512 + tid] + A.gmlp_nb[l * 512 + tid];
        A.out[O_VS + ((size_t)l * MS + r) * 512 + tid] = v;
        const int g = tid >> 7;
        const float mix = A.gmlp_ws[(size_t)(l * 4 + g) * 16384] * v + A.gmlp_bs[(l * 4 + g) * 128];
        const float u = bf2f(prow[C_GU + tid]);
        prow[C_GU + tid] = (bf16_t)f2bf(u * mix);
    }
    __syncthreads();
    {
#pragma unroll 1
        for (int gi = 0; gi < 4; ++gi) {
            const int g = 4 * w + gi;
            float u[16];
#pragma unroll
            for (int j = 0; j < 16; ++j) u[j] = bf2f(prow[C_SU + g * 16 + j]);
            float bre = 0.f, bim = 0.f;
            const bf16_t* br = C.BBAR + ((size_t)g * 128 + lane) * 16; const bf16_t* bi = C.BBAR + ((size_t)g * 128 + 64 + lane) * 16;
#pragma unroll
            for (int j = 0; j < 16; ++j) { bre += bf2f(br[j]) * u[j]; bim += bf2f(bi[j]) * u[j]; }
            const float ar = C.ABAR[(g * 64 + lane) * 2], ai = C.ABAR[(g * 64 + lane) * 2 + 1];
            const float h0r = A.state_re[((size_t)l * MS + r) * 2048 + g * 64 + lane], h0i = A.state_im[((size_t)l * MS + r) * 2048 + g * 64 + lane];
            const float hr = ar * h0r - ai * h0i + bre, hi = ar * h0i + ai * h0r + bim;
            A.out[O_RES + ((size_t)l * MS + r) * 2048 + g * 64 + lane] = hr;
            A.out[O_IMS + ((size_t)l * MS + r) * 2048 + g * 64 + lane] = hi;
            float yv = 0.f, uu = 0.f;
#pragma unroll
            for (int i = 0; i < 16; ++i) {
                const float t = wave_sum(bf2f(C.CCT[((size_t)g * 16 + i) * 128 + lane]) * hr + bf2f(C.CCT[((size_t)g * 16 + i) * 128 + 64 + lane]) * hi);
                if (lane == i) { yv = t; uu = u[i]; }
            }
            if (lane < 16) prow[C_GV + g * 16 + lane] = (bf16_t)f2bf(geluf_(yv + A.s5_d[l * 512 + g * 16 + lane] * uu));
        }
    }
    __syncthreads();
}

__device__ __forceinline__ void phase_mix1(const Args& A, const Ctx& C) {
    for (int it = blockIdx.x; it < 2176; it += gridDim.x) {
        if (it < 512) hgrn_passA(A, C, it);
        else if (it < 1024) gmlp_item(A, C, (it - 512) >> 2, (it - 512) & 3);
        else if (it < 1536) { const int r = it - 1024; s5_item<1>(A, C, r >> 6, (r >> 2) & 15, r & 3); __syncthreads(); }
        else if (it < 2048) sample_hgrn(A, C, (it - 1536) >> 2, (it - 1536) & 3);
        else sample_row(A, C, it - 2048);
    }
}
__device__ __forceinline__ void phase_mix3(const Args& A, const Ctx& C) {
    for (int it = blockIdx.x; it < 1024; it += gridDim.x) {
        if (it < 512) hgrn_passC(A, C, it);
        else { const int r = it - 512; s5_item<3>(A, C, r >> 6, (r >> 2) & 15, r & 3); __syncthreads(); }
    }
}

constexpr int PH_PER_LAYER = 15, N_PHASES = DEPTH * PH_PER_LAYER;

__global__ void __launch_bounds__(512, 2) mk_fwd(Args args) {
    extern __shared__ __attribute__((aligned(16))) unsigned char lds_raw[];
    Ctx C;
    C.lds = (LAS unsigned char*)lds_raw;
    unsigned char* ws = args.ws;
    C.X = args.out; C.H = (bf16_t*)(ws + WS_H); C.PROJ = (bf16_t*)(ws + WS_P); C.ACT = (bf16_t*)(ws + WS_P); C.Y = (float*)(ws + WS_Y); C.W = (bf16_t*)(ws + WS_W);
    C.DS = (bf16_t*)(ws + WS_H); C.DEC = (float*)(ws + WS_DEC); C.E = (float*)(ws + WS_E);
    C.LB = (float*)(ws + WS_TAB + T_LB); C.ABAR = (float*)(ws + WS_TAB + T_ABAR); C.A128 = (float*)(ws + WS_TAB + T_A128); C.BBAR = (bf16_t*)(ws + WS_TAB + T_BBAR); C.CCT = (bf16_t*)(ws + WS_TAB + T_CC);
    const int G = gridDim.x, bid = blockIdx.x;
#if MK_ONE_LAUNCH
    cg::grid_group grid = cg::this_grid();
#endif
    for (int ph = args.ph_lo; ph < args.ph_hi; ++ph) {
        const int l = ph / PH_PER_LAYER, k = ph % PH_PER_LAYER;
        C.l = l;
        const float* ng = args.norm_g + (size_t)l * 6 * DM;
        switch (k) {
        case 0: phase_weights(args, C); if (l == 0) phase_norm(args, C, 0, 0.f, nullptr, ng); break;
        case 1: case 12: {
            pg8::Gemm g{C.H, C.W + (k == 1 ? W_GU0 : W_GU1), DM, DM, MPAD, 2 * FF, DM}; pg8::StaticOrder S; S.init(MPAD, 2 * FF, G, bid);
            pg8::EpiSwiGLU E{C.ACT, FF}; pg8::gemm_phase(C.lds, g, S, E); } break;
        case 2: case 13: {
            pg8::Gemm g{C.ACT, C.W + (k == 2 ? W_D0 : W_D1), FF, FF, MPAD, DM, FF}; pg8::StaticOrder S; S.init(MPAD, DM, G, bid);
            pg8::EpiF32 E{C.Y, DM}; pg8::gemm_phase(C.lds, g, S, E); } break;
        case 3: phase_norm(args, C, 1, 0.5f, ng + DM, ng + 2 * DM); break;
        case 4: {
            pg8::Gemm g{C.H, C.W + W_IN, DM, DM, MPAD, NIN, DM}; pg8::StaticOrder S; S.init(MPAD, NIN, G, bid);
            pg8::EpiProj E{C.PROJ, NIN}; pg8::gemm_phase(C.lds, g, S, E); } break;
        case 5: phase_mix1(args, C); break;
        case 6: hgrn_passB(args, C); break;
        case 7: phase_mix3(args, C); break;
        case 8: {
            pg8::Gemm g{C.PROJ + C_GV, C.W + W_GLU, NIN, 512, MPAD, 1024, 512}; pg8::StaticOrder S; S.init(MPAD, 1024, G, bid);
            pg8::EpiGLU E{C.PROJ + C_SU, NIN, args.glu_b + (size_t)l * 1024}; pg8::gemm_phase(C.lds, g, S, E); } break;
        case 9: {
            pg8::Gemm g{C.PROJ, C.W + W_BR, NIN, 1536, MPAD, DM, 1536}; pg8::StaticOrder S; S.init(MPAD, DM, G, bid);
            pg8::EpiMerge E{C.H, DM, C.PROJ + C_GATE, NIN}; pg8::gemm_phase(C.lds, g, S, E); } break;
        case 10: {
            pg8::Gemm g{C.H, C.W + W_OUT, DM, DM, MPAD, DM, DM}; pg8::StaticOrder S; S.init(MPAD, DM, G, bid);
            pg8::EpiF32 E{C.Y, DM}; pg8::gemm_phase(C.lds, g, S, E); } break;
        case 11: phase_norm(args, C, 1, 1.0f, ng + 3 * DM, ng + 4 * DM); break;
        case 14: phase_norm(args, C, 1, 0.5f, ng + 5 * DM, (l + 1 < DEPTH) ? args.norm_g + (size_t)(l + 1) * 6 * DM : nullptr); break;
        }
#if MK_ONE_LAUNCH
        if (ph + 1 < args.ph_hi) grid.sync();
#endif
    }
}

extern "C" void kernel_launch(void* const* d_in, const int* in_sizes, int n_in, void* d_out, int out_size, void* d_ws, size_t ws_size, hipStream_t stream) {
    static int grid = 0;
    if (grid == 0) {
        if (n_in != 28 || ws_size < WS_END) { fprintf(stderr, "kernel_launch: unexpected n_in %d or ws_size %zu (need %zu)\n", n_in, ws_size, (size_t)WS_END); grid = -1; return; }
        int dev = 0, cus = 0;
        hipGetDevice(&dev); hipDeviceGetAttribute(&cus, hipDeviceAttributeMultiprocessorCount, dev);
        if (hipFuncSetAttribute((const void*)mk_fwd, hipFuncAttributeMaxDynamicSharedMemorySize, LDS_BYTES) != hipSuccess) { fprintf(stderr, "kernel_launch: hipFuncSetAttribute failed\n"); grid = -1; return; }
        int per_cu = 0;
        hipOccupancyMaxActiveBlocksPerMultiprocessor(&per_cu, (const void*)mk_fwd, 512, LDS_BYTES);
        (void)hipGetLastError();
        grid = cus > 0 ? cus : 256;
        if (per_cu < 1) fprintf(stderr, "kernel_launch: occupancy query reports %d blocks/CU\n", per_cu);
    }
    if (grid < 0) return;
    Args a{};
    const float* const* in = (const float* const*)d_in;
    a.x_prompt = in[0]; a.x_sample = in[1]; a.state_hgrn = in[2]; a.state_re = in[3]; a.state_im = in[4];
    a.norm_g = in[5]; a.w_gate = in[6]; a.w_up = in[7]; a.w_down = in[8]; a.w_in = in[9];
    a.lb_logits = in[10]; a.hgrn_ng = in[11]; a.gmlp_ws = in[12]; a.gmlp_bs = in[13]; a.gmlp_ng = in[14]; a.gmlp_nb = in[15];
    a.lam_re = in[16]; a.lam_im = in[17]; a.log_dt = in[18]; a.b_re = in[19]; a.b_im = in[20]; a.c_re = in[21]; a.c_im = in[22]; a.s5_d = in[23];
    a.glu_w = in[24]; a.glu_b = in[25]; a.w_branch = in[26]; a.w_out = in[27];
    a.out = (float*)d_out; a.ws = (unsigned char*)d_ws;
#if MK_ONE_LAUNCH
    a.ph_lo = 0; a.ph_hi = N_PHASES;
    void* kargs[] = {&a};
    hipError_t e = hipLaunchCooperativeKernel((const void*)mk_fwd, dim3(grid), dim3(512), kargs, LDS_BYTES, stream);
    if (e != hipSuccess) fprintf(stderr, "cooperative launch failed: %s (grid %d)\n", hipGetErrorString(e), grid);
#else
    for (int ph = 0; ph < N_PHASES; ++ph) {
        a.ph_lo = ph; a.ph_hi = ph + 1;
        hipLaunchKernelGGL(mk_fwd, dim3(grid), dim3(512), LDS_BYTES, stream, a);
    }
#endif
}
```
